# Optimizing an MI355X kernel written in HIP

```python
import math
import jax
import jax.numpy as jnp
from jax import lax
import numpy as np

D_MODEL = 1024
BATCH = 16
SEQ = 2048
DEPTH = 4
DEC_BATCH = 8
DEC_SEQ = 64
PAST_LEN = 1024

CHUNK = 64
N_A_LAYERS = DEPTH // 2
N_B_LAYERS = DEPTH - N_A_LAYERS
SSM_WIDTH = D_MODEL
SSM_GROUP_CH = 16
SSM_GROUPS = SSM_WIDTH // SSM_GROUP_CH
SSM_STATE = 64
DT_MIN = 1e-3
DT_MAX = 1e-1
HEAD_DIM = 64
N_HEADS = D_MODEL // HEAD_DIM
N_KV_HEADS = 4
Q_PER_KV = N_HEADS // N_KV_HEADS
ATTN_WIDTH = N_HEADS * HEAD_DIM
KV_WIDTH = N_KV_HEADS * HEAD_DIM
WINDOW = 128
WINDOW_CHUNKS = WINDOW // CHUNK
ROPE_THETA = 10000.0
NEG_INF = -1e30
DEEPNORM_ALPHA = (2.0 * DEPTH) ** 0.25
DEEPNORM_BETA = (8.0 * DEPTH) ** -0.25
LN_EPS = 1e-5

kernel_name = 'yoco_s5_swa_sink_streaming_step'


def layer_norm(x, g, b):
    xf = x.astype(jnp.float32)
    mu = jnp.mean(xf, axis=-1, keepdims=True)
    var = jnp.mean(jnp.square(xf - mu), axis=-1, keepdims=True)
    y = (xf - mu) * lax.rsqrt(var + LN_EPS) * g.astype(jnp.float32) + b.astype(jnp.float32)
    return y.astype(x.dtype)


def ada_params(c, w, b):
    cond = jax.nn.silu(c) @ w + b
    shift, scale, gate = jnp.split(cond, 3, axis=-1)
    return shift[:, None], scale[:, None], gate[:, None]


def rope(x, pos):
    half = HEAD_DIM // 2
    inv_freq = jnp.power(ROPE_THETA, -jnp.arange(half, dtype=jnp.float32) / half)
    ang = pos.astype(jnp.float32)[:, None] * inv_freq[None, :]
    cos = jnp.cos(ang)[None, :, None, :]
    sin = jnp.sin(ang)[None, :, None, :]
    xf = x.astype(jnp.float32)
    x1, x2 = xf[..., :half], xf[..., half:]
    out = jnp.concatenate([x1 * cos - x2 * sin, x2 * cos + x1 * sin], axis=-1)
    return out.astype(x.dtype)


def s5_scan(u, h0, a_re, a_im, b_re, b_im, c_re, c_im, d, log_dt):
    f32 = jnp.float32
    bsz, seq_len, _ = u.shape
    lam = lax.complex(a_re.astype(f32), a_im.astype(f32))
    dt = jnp.exp(log_dt.astype(f32))[:, None]
    a_bar = jnp.exp(lam * dt)
    b_bar = ((a_bar - 1.0) / lam)[..., None] * lax.complex(b_re.astype(f32), b_im.astype(f32))
    uf = u.astype(f32)
    ug = uf.reshape(bsz, seq_len, SSM_GROUPS, SSM_GROUP_CH).astype(jnp.complex64)
    bu = jnp.einsum('gpc,blgc->blgp', b_bar, ug)
    bu = bu.at[:, 0].add(a_bar[None] * h0)
    a_seq = jnp.broadcast_to(a_bar, (1, seq_len) + a_bar.shape)

    def combine(e1, e2):
        a1, b1 = e1
        a2, b2 = e2
        return a1 * a2, a2 * b1 + b2

    _, h = lax.associative_scan(combine, (a_seq, bu), axis=1)
    c_mat = lax.complex(c_re.astype(f32), c_im.astype(f32))
    y = jnp.real(jnp.einsum('gcp,blgp->blgc', c_mat, h)).reshape(bsz, seq_len, SSM_WIDTH)
    y = y + d.astype(f32) * uf
    return y.astype(u.dtype), h[:, -1]


def ssm_branch(hmod, la, h0, p):
    uz = hmod @ p['w_in_a'][la]
    u, z = jnp.split(uz, 2, axis=-1)
    y, h_last = s5_scan(u, h0, p['ssm_a_re'][la], p['ssm_a_im'][la], p['ssm_b_re'][la], p['ssm_b_im'][la],
                        p['ssm_c_re'][la], p['ssm_c_im'][la], p['ssm_d'][la], p['ssm_log_dt'][la])
    g = jax.nn.gelu(y)
    y = g * jax.nn.sigmoid(g @ p['w_glu'][la] + p['b_glu'][la])
    y = y * jax.nn.silu(z)
    return y @ p['w_out_a'][la], h_last


def shared_kv(x, w_kv, pos):
    bsz, seq_len, _ = x.shape
    kv = x @ w_kv
    k, v = jnp.split(kv, 2, axis=-1)
    k = rope(k.reshape(bsz, seq_len, N_KV_HEADS, HEAD_DIM), pos)
    v = v.reshape(bsz, seq_len, N_KV_HEADS, HEAD_DIM)
    return k, v


def sink_attention(q, k, v, sinks, mask):
    s = jnp.einsum('ncqkgd,ncjkd->nckgqj', q, k).astype(jnp.float32) * (HEAD_DIM ** -0.5)
    if mask is not None:
        s = jnp.where(mask, s, NEG_INF)
    sink = sinks.astype(jnp.float32).reshape(1, 1, N_KV_HEADS, Q_PER_KV, 1, 1)
    m = jnp.maximum(jnp.max(s, axis=-1, keepdims=True), sink)
    e = jnp.exp(s - m)
    denom = jnp.sum(e, axis=-1, keepdims=True) + jnp.exp(sink - m)
    probs = (e / denom).astype(v.dtype)
    return jnp.einsum('nckgqj,ncjkd->ncqkgd', probs, v)


def banded_window_attention(q, k, v, sinks):
    bsz, seq_len = q.shape[:2]
    n_chunks = seq_len // CHUNK
    qb = q.reshape(bsz, n_chunks, CHUNK, N_KV_HEADS, Q_PER_KV, HEAD_DIM)
    pad = ((0, 0), (WINDOW, 0), (0, 0), (0, 0))
    kp = jnp.pad(k, pad).reshape(bsz, n_chunks + WINDOW_CHUNKS, CHUNK, N_KV_HEADS, HEAD_DIM)
    vp = jnp.pad(v, pad).reshape(bsz, n_chunks + WINDOW_CHUNKS, CHUNK, N_KV_HEADS, HEAD_DIM)
    kb = jnp.concatenate([kp[:, i:i + n_chunks] for i in range(WINDOW_CHUNKS + 1)], axis=2)
    vb = jnp.concatenate([vp[:, i:i + n_chunks] for i in range(WINDOW_CHUNKS + 1)], axis=2)
    key_pos = (jnp.arange(n_chunks)[:, None] * CHUNK
               + jnp.arange((WINDOW_CHUNKS + 1) * CHUNK)[None, :] - WINDOW)
    mask = (key_pos >= 0)[None, :, None, None, None, :]
    o = sink_attention(qb, kb, vb, sinks, mask)
    return o.reshape(bsz, seq_len, ATTN_WIDTH)


def cached_window_attention(q, k_new, v_new, cache_k, cache_v, sinks):
    bsz, t_new = q.shape[:2]
    qb = q.reshape(bsz, 1, t_new, N_KV_HEADS, Q_PER_KV, HEAD_DIM)
    kb = jnp.concatenate([cache_k, k_new], axis=1)[:, None]
    vb = jnp.concatenate([cache_v, v_new], axis=1)[:, None]
    o = sink_attention(qb, kb, vb, sinks, None)
    return o.reshape(bsz, t_new, ATTN_WIDTH)


def attn_branch(hmod, lb, pos, k_sh, v_sh, cache_k, cache_v, p):
    bsz, seq_len, _ = hmod.shape
    qz = hmod @ p['w_in_b'][lb]
    q, z = jnp.split(qz, 2, axis=-1)
    q = rope(q.reshape(bsz, seq_len, N_HEADS, HEAD_DIM), pos)
    if cache_k is None:
        o = banded_window_attention(q, k_sh, v_sh, p['attn_sinks'][lb])
    else:
        o = cached_window_attention(q, k_sh, v_sh, cache_k, cache_v, p['attn_sinks'][lb])
    o = o * jax.nn.silu(z)
    return o @ p['w_out_b'][lb]


def run_trunk(x, c, pos, h0, cache_k, cache_v, p):
    new_h = []
    k_sh = None
    v_sh = None
    for layer in range(DEPTH):
        shift, scale, gate = ada_params(c, p['w_ada'][layer], p['b_ada'][layer])
        if layer == N_A_LAYERS:
            k_sh, v_sh = shared_kv(x, p['w_kv'], pos)
        hmod = x * (1.0 + scale) + shift
        if layer < N_A_LAYERS:
            out, h_last = ssm_branch(hmod, layer, h0[layer], p)
            new_h.append(h_last)
        else:
            out = attn_branch(hmod, layer - N_A_LAYERS, pos, k_sh, v_sh, cache_k, cache_v, p)
        x = layer_norm(DEEPNORM_ALPHA * x + gate * out, p['ln_g'][layer], p['ln_b'][layer])
    h_stack = jnp.stack(new_h)
    state = jnp.stack([jnp.real(h_stack), jnp.imag(h_stack)], axis=-1)
    return x, state, k_sh, v_sh


def setup_inputs(seed: int = 0) -> dict:
    key = jax.random.key(seed)
    ks = jax.random.split(key, 32)
    f32 = jnp.float32

    def nrm(k, shape, s):
        return jax.random.normal(k, shape, f32) * s

    kv_rows = min(WINDOW, PAST_LEN)
    n_idx = jnp.arange(SSM_STATE, dtype=f32)
    ga = (N_A_LAYERS, SSM_GROUPS, SSM_STATE)
    return {
        'x_prompt': nrm(ks[0], (BATCH, SEQ, D_MODEL), 1.0),
        'x_sample': nrm(ks[1], (DEC_BATCH, DEC_SEQ, D_MODEL), 1.0),
        'state_ssm': nrm(ks[2], (N_A_LAYERS, DEC_BATCH, SSM_GROUPS, SSM_STATE, 2), 0.1),
        'cache_k': nrm(ks[3], (DEC_BATCH, kv_rows, N_KV_HEADS, HEAD_DIM), 1.0),
        'cache_v': nrm(ks[4], (DEC_BATCH, kv_rows, N_KV_HEADS, HEAD_DIM), 1.0),
        'c_prompt': nrm(ks[5], (BATCH, D_MODEL), 1.0),
        'c_sample': nrm(ks[6], (DEC_BATCH, D_MODEL), 1.0),
        'w_ada': nrm(ks[7], (DEPTH, D_MODEL, 3 * D_MODEL), 0.5 * D_MODEL ** -0.5),
        'b_ada': nrm(ks[8], (DEPTH, 3 * D_MODEL), 0.01),
        'ln_g': 1.0 + nrm(ks[9], (DEPTH, D_MODEL), 0.02),
        'ln_b': nrm(ks[10], (DEPTH, D_MODEL), 0.02),
        'w_in_a': nrm(ks[11], (N_A_LAYERS, D_MODEL, 2 * SSM_WIDTH), D_MODEL ** -0.5),
        'ssm_a_re': -0.5 + nrm(ks[12], ga, 0.01),
        'ssm_a_im': math.pi * n_idx + nrm(ks[13], ga, 0.01),
        'ssm_b_re': nrm(ks[14], ga + (SSM_GROUP_CH,), (2.0 * SSM_GROUP_CH) ** -0.5),
        'ssm_b_im': nrm(ks[15], ga + (SSM_GROUP_CH,), (2.0 * SSM_GROUP_CH) ** -0.5),
        'ssm_c_re': nrm(ks[16], (N_A_LAYERS, SSM_GROUPS, SSM_GROUP_CH, SSM_STATE), SSM_STATE ** -0.5),
        'ssm_c_im': nrm(ks[17], (N_A_LAYERS, SSM_GROUPS, SSM_GROUP_CH, SSM_STATE), SSM_STATE ** -0.5),
        'ssm_d': nrm(ks[18], (N_A_LAYERS, SSM_WIDTH), 1.0),
        'ssm_log_dt': jax.random.uniform(ks[19], (N_A_LAYERS, SSM_GROUPS), f32,
                                         math.log(DT_MIN), math.log(DT_MAX)),
        'w_glu': nrm(ks[20], (N_A_LAYERS, SSM_WIDTH, SSM_WIDTH), SSM_WIDTH ** -0.5),
        'b_glu': nrm(ks[21], (N_A_LAYERS, SSM_WIDTH), 0.01),
        'w_out_a': nrm(ks[22], (N_A_LAYERS, SSM_WIDTH, D_MODEL), SSM_WIDTH ** -0.5 * DEEPNORM_BETA),
        'w_kv': nrm(ks[23], (D_MODEL, 2 * KV_WIDTH), D_MODEL ** -0.5),
        'w_in_b': nrm(ks[24], (N_B_LAYERS, D_MODEL, 2 * ATTN_WIDTH), D_MODEL ** -0.5),
        'attn_sinks': nrm(ks[25], (N_B_LAYERS, N_HEADS), 0.5),
        'w_out_b': nrm(ks[26], (N_B_LAYERS, ATTN_WIDTH, D_MODEL), ATTN_WIDTH ** -0.5 * DEEPNORM_BETA),
    }


def reference(x_prompt, x_sample, state_ssm, cache_k, cache_v, c_prompt, c_sample,
              w_ada, b_ada, ln_g, ln_b, w_in_a, ssm_a_re, ssm_a_im, ssm_b_re, ssm_b_im,
              ssm_c_re, ssm_c_im, ssm_d, ssm_log_dt, w_glu, b_glu, w_out_a,
              w_kv, w_in_b, attn_sinks, w_out_b):
    p = dict(w_ada=w_ada, b_ada=b_ada, ln_g=ln_g, ln_b=ln_b, w_in_a=w_in_a,
             ssm_a_re=ssm_a_re, ssm_a_im=ssm_a_im, ssm_b_re=ssm_b_re, ssm_b_im=ssm_b_im,
             ssm_c_re=ssm_c_re, ssm_c_im=ssm_c_im, ssm_d=ssm_d, ssm_log_dt=ssm_log_dt,
             w_glu=w_glu, b_glu=b_glu, w_out_a=w_out_a, w_kv=w_kv, w_in_b=w_in_b,
             attn_sinks=attn_sinks, w_out_b=w_out_b)
    pos_prompt = jnp.arange(x_prompt.shape[1], dtype=jnp.int32)
    pos_sample = PAST_LEN + jnp.arange(x_sample.shape[1], dtype=jnp.int32)
    h0_prompt = jnp.zeros((N_A_LAYERS, x_prompt.shape[0], SSM_GROUPS, SSM_STATE), jnp.complex64)
    h0_sample = lax.complex(state_ssm[..., 0].astype(jnp.float32), state_ssm[..., 1].astype(jnp.float32))
    y_prompt, ssm_p, k_p, v_p = run_trunk(x_prompt, c_prompt, pos_prompt, h0_prompt, None, None, p)
    y_sample, ssm_s, k_s, v_s = run_trunk(x_sample, c_sample, pos_sample, h0_sample, cache_k, cache_v, p)
    rows = min(WINDOW, x_prompt.shape[1])
    return (y_prompt, y_sample, ssm_p, k_p[:, -rows:], v_p[:, -rows:], ssm_s, k_s, v_s)
```

```cpp
#include <hip/hip_runtime.h>
#include <cstdio>
#include <cstdint>
namespace gold {
constexpr int D = 1024, NPB = 16, PL = 2048, NSB = 8, SL = 64, G = 64, P = 64, GC = 16, H = 16, KVH = 4, HD = 64, KVW = 256;
constexpr float ALPHA = 1.681792830507429f, LNEPS = 1e-5f;

__device__ __forceinline__ float silu_f(float v) { return v / (1.f + expf(-v)); }
__device__ __forceinline__ float gelu_f(float v) { return 0.5f * v * (1.f + tanhf(0.7978845608028654f * (v + 0.044715f * v * v * v))); }

__global__ void k_ada(const float* cp, const float* cs, const float* w_ada, const float* b_ada, float* cond) {
    const int col = blockIdx.x * blockDim.x + threadIdx.x;
    const int b = blockIdx.y, l = blockIdx.z;
    const float* c = b < 16 ? cp + (size_t)b * D : cs + (size_t)(b - 16) * D;
    const float* w = w_ada + (size_t)l * D * 3072;
    float acc = 0.f;
    for (int k = 0; k < D; ++k) acc += silu_f(c[k]) * w[(size_t)k * 3072 + col];
    cond[((size_t)l * 24 + b) * 3072 + col] = acc + b_ada[l * 3072 + col];
}
__global__ void k_mod(const float* x, const float* cond_lb, float* hm, int n) {
    const int i = blockIdx.x * blockDim.x + threadIdx.x; if (i >= n) return;
    const int c = i & (D - 1);
    hm[i] = x[i] * (1.f + cond_lb[1024 + c]) + cond_lb[c];
}
__global__ void __launch_bounds__(256) k_gemm(const float* A, int lda, const float* W, int ldw, float* C, int ldc, int K) {
    __shared__ float As[16][64 + 4];
    __shared__ float Bs[16][64 + 4];
    const int tid = threadIdx.x, tx = tid & 15, ty = tid >> 4;
    const int m0 = blockIdx.y * 64, n0 = blockIdx.x * 64;
    float acc[4][4] = {};
    for (int k0 = 0; k0 < K; k0 += 16) {
        { const int r = tid >> 2, kc = (tid & 3) * 4; const float4 v = *(const float4*)(A + (size_t)(m0 + r) * lda + k0 + kc);
          As[kc + 0][r] = v.x; As[kc + 1][r] = v.y; As[kc + 2][r] = v.z; As[kc + 3][r] = v.w; }
        { const int kr = tid >> 4, nc = (tid & 15) * 4; const float4 v = *(const float4*)(W + (size_t)(k0 + kr) * ldw + n0 + nc);
          Bs[kr][nc + 0] = v.x; Bs[kr][nc + 1] = v.y; Bs[kr][nc + 2] = v.z; Bs[kr][nc + 3] = v.w; }
        __syncthreads();
#pragma unroll
        for (int kk = 0; kk < 16; ++kk) {
            float a[4], b[4];
#pragma unroll
            for (int i = 0; i < 4; ++i) { a[i] = As[kk][ty * 4 + i]; b[i] = Bs[kk][tx * 4 + i]; }
#pragma unroll
            for (int i = 0; i < 4; ++i)
#pragma unroll
                for (int j = 0; j < 4; ++j) acc[i][j] += a[i] * b[j];
        }
        __syncthreads();
    }
#pragma unroll
    for (int i = 0; i < 4; ++i)
#pragma unroll
        for (int j = 0; j < 4; ++j) C[(size_t)(m0 + ty * 4 + i) * ldc + n0 + tx * 4 + j] = acc[i][j];
}
__global__ void k_s5_params(const float* a_re, const float* a_im, const float* b_re, const float* b_im, const float* log_dt, float* abar, float* bbar) {
    const int i = blockIdx.x * blockDim.x + threadIdx.x; if (i >= 2 * G * P) return;
    const int lg = i / P;
    const double dt = exp((double)log_dt[lg]);
    const double lr = a_re[i], li = a_im[i];
    const double er = exp(lr * dt), ar = er * cos(li * dt), ai = er * sin(li * dt);
    abar[2 * i] = (float)ar; abar[2 * i + 1] = (float)ai;
    const double nr = ar - 1.0, ni = ai, den = lr * lr + li * li;
    const double qr = (nr * lr + ni * li) / den, qi = (ni * lr - nr * li) / den;
    for (int c = 0; c < GC; ++c) {
        const double br = b_re[(size_t)i * GC + c], bi = b_im[(size_t)i * GC + c];
        bbar[((size_t)i * GC + c) * 2] = (float)(qr * br - qi * bi);
        bbar[((size_t)i * GC + c) * 2 + 1] = (float)(qr * bi + qi * br);
    }
}
__global__ void __launch_bounds__(64) k_s5(const float* uz, int L, const float* abar_l, const float* bbar_l, const float* c_re_l, const float* c_im_l,
                                            const float* d_l, const float* h0, float* y, float* hlast) {
    const int g = blockIdx.x, p = threadIdx.x;
    const float ar = abar_l[(g * P + p) * 2], ai = abar_l[(g * P + p) * 2 + 1];
    float br[GC], bi[GC], cr[GC], ci[GC];
#pragma unroll
    for (int c = 0; c < GC; ++c) { br[c] = bbar_l[((size_t)(g * P + p) * GC + c) * 2]; bi[c] = bbar_l[((size_t)(g * P + p) * GC + c) * 2 + 1];
        cr[c] = c_re_l[((size_t)g * GC + c) * P + p]; ci[c] = c_im_l[((size_t)g * GC + c) * P + p]; }
    float hr = h0 ? h0[(g * P + p) * 2] : 0.f, hi = h0 ? h0[(g * P + p) * 2 + 1] : 0.f;
    for (int t = 0; t < L; ++t) {
        const float* ut = uz + (size_t)t * 2048 + g * GC;
        float bur = 0.f, bui = 0.f;
#pragma unroll
        for (int c = 0; c < GC; ++c) { const float u = ut[c]; bur += br[c] * u; bui += bi[c] * u; }
        const float nr = ar * hr - ai * hi + bur, ni = ar * hi + ai * hr + bui;
        hr = nr; hi = ni;
#pragma unroll
        for (int c = 0; c < GC; ++c) {
            float v = cr[c] * hr - ci[c] * hi;
#pragma unroll
            for (int o = 32; o >= 1; o >>= 1) v += __shfl_xor(v, o);
            if (p == c) y[(size_t)t * D + g * GC + c] = v + d_l[g * GC + c] * ut[c];
        }
    }
    hlast[(g * P + p) * 2] = hr; hlast[(g * P + p) * 2 + 1] = hi;
}
__global__ void k_gelu(float* y, int n) { const int i = blockIdx.x * blockDim.x + threadIdx.x; if (i < n) y[i] = gelu_f(y[i]); }
__global__ void k_glu(const float* g, const float* t, const float* bglu, const float* uz, float* y2, int n) {
    const int i = blockIdx.x * blockDim.x + threadIdx.x; if (i >= n) return;
    const int c = i & (D - 1), r = i >> 10;
    const float z = uz[(size_t)r * 2048 + 1024 + c];
    y2[i] = g[i] * (1.f / (1.f + expf(-(t[i] + bglu[c])))) * silu_f(z);
}
__global__ void __launch_bounds__(256) k_ln(const float* xin, const float* out, const float* cond_lb, const float* lg, const float* lb, float* xout) {
    __shared__ float red[256];
    const int r = blockIdx.x, tid = threadIdx.x;
    float v[4]; float s = 0.f;
#pragma unroll
    for (int j = 0; j < 4; ++j) { const int c = tid + 256 * j; v[j] = ALPHA * xin[(size_t)r * D + c] + cond_lb[2048 + c] * out[(size_t)r * D + c]; s += v[j]; }
    red[tid] = s; __syncthreads();
    for (int o = 128; o >= 1; o >>= 1) { if (tid < o) red[tid] += red[tid + o]; __syncthreads(); }
    const float mu = red[0] * (1.f / D); __syncthreads();
    float q = 0.f;
#pragma unroll
    for (int j = 0; j < 4; ++j) { const float d = v[j] - mu; q += d * d; }
    red[tid] = q; __syncthreads();
    for (int o = 128; o >= 1; o >>= 1) { if (tid < o) red[tid] += red[tid + o]; __syncthreads(); }
    const float rstd = 1.f / sqrtf(red[0] * (1.f / D) + LNEPS);
#pragma unroll
    for (int j = 0; j < 4; ++j) { const int c = tid + 256 * j; xout[(size_t)r * D + c] = (v[j] - mu) * rstd * lg[c] + lb[c]; }
}
__global__ void k_rope(float* q, int ld, int nh, int L, int pos0) {
    const int i = blockIdx.x * blockDim.x + threadIdx.x; if (i >= L * nh * 32) return;
    const int j = i & 31, h = (i >> 5) % nh, t = i / (32 * nh);
    const double inv = pow(10000.0, -(double)j / 32.0), ang = (double)(pos0 + t) * inv;
    const float cs = (float)cos(ang), sn = (float)sin(ang);
    float* p = q + (size_t)t * ld + h * 64;
    const float x1 = p[j], x2 = p[j + 32];
    p[j] = x1 * cs - x2 * sn; p[j + 32] = x2 * cs + x1 * sn;
}
__global__ void k_attn(const float* qz, const float* kn, const float* vn, int ldkv, const float* kc, const float* vc, int nc, const float* sinks, int L, float* o) {
    const int i = blockIdx.x * blockDim.x + threadIdx.x; if (i >= L * H) return;
    const int h = i % H, t = i / H, kvh = h >> 2;
    const float* q = qz + (size_t)t * 2048 + h * 64;
    const float sink = sinks[h];
    int j0, j1;
    if (nc == 0) { const int c = t / 64; j0 = (c - 2) * 64; if (j0 < 0) j0 = 0; j1 = (c + 1) * 64; } else { j0 = 0; j1 = L; }
    float m = sink;
    for (int pass = 0; pass < 1; ++pass) {
        for (int j = 0; j < nc; ++j) { const float* k = kc + (size_t)j * 256 + kvh * 64; float s = 0.f; for (int d = 0; d < 64; ++d) s += q[d] * k[d]; s *= 0.125f; m = fmaxf(m, s); }
        for (int j = j0; j < j1; ++j) { const float* k = kn + (size_t)j * ldkv + kvh * 64; float s = 0.f; for (int d = 0; d < 64; ++d) s += q[d] * k[d]; s *= 0.125f; m = fmaxf(m, s); }
    }
    float den = expf(sink - m); float acc[64];
#pragma unroll
    for (int d = 0; d < 64; ++d) acc[d] = 0.f;
    for (int j = 0; j < nc; ++j) { const float* k = kc + (size_t)j * 256 + kvh * 64; const float* v = vc + (size_t)j * 256 + kvh * 64; float s = 0.f; for (int d = 0; d < 64; ++d) s += q[d] * k[d];
        const float e = expf(s * 0.125f - m); den += e;
#pragma unroll
        for (int d = 0; d < 64; ++d) acc[d] += e * v[d]; }
    for (int j = j0; j < j1; ++j) { const float* k = kn + (size_t)j * ldkv + kvh * 64; const float* v = vn + (size_t)j * ldkv + kvh * 64; float s = 0.f; for (int d = 0; d < 64; ++d) s += q[d] * k[d];
        const float e = expf(s * 0.125f - m); den += e;
#pragma unroll
        for (int d = 0; d < 64; ++d) acc[d] += e * v[d]; }
    const float inv = 1.f / den;
    const float* z = qz + (size_t)t * 2048 + 1024 + h * 64;
#pragma unroll
    for (int d = 0; d < 64; ++d) o[(size_t)t * D + h * 64 + d] = acc[d] * inv * silu_f(z[d]);
}
__global__ void k_copy_rows(const float* src, int lds, float* dst, int ldd, int rows, int cols) {
    const int i = blockIdx.x * blockDim.x + threadIdx.x; if (i >= rows * cols) return;
    const int r = i / cols, c = i % cols; dst[(size_t)r * ldd + c] = src[(size_t)r * lds + c];
}

struct Bufs { float *cond, *abar, *bbar, *x0, *x1, *hm, *uz, *y, *t, *y2, *kv; };
typedef void (*Hook)(void* ctx, int seq, int layer, int stage, const float* data, int ld, int rows, int cols, hipStream_t st);
enum Stage { ST_HMOD = 0, ST_U, ST_Z, ST_Y, ST_G, ST_Y2, ST_OUT, ST_X, ST_K, ST_V, ST_Q, ST_O };

static void run(void* const* d_in, float* d_out, char* ws, hipStream_t st, Hook hook, void* hctx) {
    const float* x_prompt = (const float*)d_in[0]; const float* x_sample = (const float*)d_in[1]; const float* state_ssm = (const float*)d_in[2];
    const float* cache_k = (const float*)d_in[3]; const float* cache_v = (const float*)d_in[4]; const float* c_prompt = (const float*)d_in[5]; const float* c_sample = (const float*)d_in[6];
    const float* w_ada = (const float*)d_in[7]; const float* b_ada = (const float*)d_in[8]; const float* ln_g = (const float*)d_in[9]; const float* ln_b = (const float*)d_in[10];
    const float* w_in_a = (const float*)d_in[11]; const float* a_re = (const float*)d_in[12]; const float* a_im = (const float*)d_in[13]; const float* b_re = (const float*)d_in[14];
    const float* b_im = (const float*)d_in[15]; const float* c_re = (const float*)d_in[16]; const float* c_im = (const float*)d_in[17]; const float* ssm_d = (const float*)d_in[18];
    const float* log_dt = (const float*)d_in[19]; const float* w_glu = (const float*)d_in[20]; const float* b_glu = (const float*)d_in[21]; const float* w_out_a = (const float*)d_in[22];
    const float* w_kv = (const float*)d_in[23]; const float* w_in_b = (const float*)d_in[24]; const float* sinks = (const float*)d_in[25]; const float* w_out_b = (const float*)d_in[26];
    float* y_prompt = d_out; float* y_sample = d_out + 33554432; float* st_p = y_sample + 524288; float* ck_p = st_p + 262144; float* cv_p = ck_p + 524288;
    float* st_s = cv_p + 524288; float* ck_s = st_s + 131072; float* cv_s = ck_s + 131072;
    Bufs B; size_t off = 0; auto take = [&](size_t nfl) { float* p = (float*)(ws + off); off += ((nfl * 4 + 255) / 256) * 256; return p; };
    B.cond = take(4 * 24 * 3072); B.abar = take(2 * G * P * 2); B.bbar = take((size_t)2 * G * P * GC * 2);
    B.x0 = take((size_t)PL * D); B.x1 = take((size_t)PL * D); B.hm = take((size_t)PL * D); B.uz = take((size_t)PL * 2048); B.y = take((size_t)PL * D); B.t = take((size_t)PL * D); B.y2 = take((size_t)PL * D); B.kv = take((size_t)PL * 512);
    k_ada<<<dim3(3072 / 256, 24, 4), 256, 0, st>>>(c_prompt, c_sample, w_ada, b_ada, B.cond);
    k_s5_params<<<(2 * G * P + 255) / 256, 256, 0, st>>>(a_re, a_im, b_re, b_im, log_dt, B.abar, B.bbar);
    for (int seq = 0; seq < 24; ++seq) {
        const bool samp = seq >= 16; const int bs = samp ? seq - 16 : seq; const int L = samp ? SL : PL; const int n = L * D;
        const float* xin = samp ? x_sample + (size_t)bs * SL * D : x_prompt + (size_t)bs * PL * D;
        float* xfinal = samp ? y_sample + (size_t)bs * SL * D : y_prompt + (size_t)bs * PL * D;
        const float* xc = xin;
        for (int l = 0; l < 4; ++l) {
            const float* cond_lb = B.cond + ((size_t)l * 24 + seq) * 3072;
            float* xn = (l == 3) ? xfinal : ((l & 1) ? B.x1 : B.x0);
            k_mod<<<(n + 255) / 256, 256, 0, st>>>(xc, cond_lb, B.hm, n);
            if (hook) hook(hctx, seq, l, ST_HMOD, B.hm, D, L, D, st);
            if (l == 2) {
                k_gemm<<<dim3(512 / 64, L / 64), 256, 0, st>>>(xc, D, w_kv, 512, B.kv, 512, D);
                k_rope<<<(L * KVH * 32 + 255) / 256, 256, 0, st>>>(B.kv, 512, KVH, L, samp ? 1024 : 0);
                if (hook) { hook(hctx, seq, l, ST_K, B.kv, 512, L, 256, st); hook(hctx, seq, l, ST_V, B.kv + 256, 512, L, 256, st); }
                if (samp) { k_copy_rows<<<(L * 256 + 255) / 256, 256, 0, st>>>(B.kv, 512, ck_s + (size_t)bs * SL * 256, 256, L, 256);
                            k_copy_rows<<<(L * 256 + 255) / 256, 256, 0, st>>>(B.kv + 256, 512, cv_s + (size_t)bs * SL * 256, 256, L, 256); }
                else { k_copy_rows<<<(128 * 256 + 255) / 256, 256, 0, st>>>(B.kv + (size_t)(PL - 128) * 512, 512, ck_p + (size_t)bs * 128 * 256, 256, 128, 256);
                       k_copy_rows<<<(128 * 256 + 255) / 256, 256, 0, st>>>(B.kv + (size_t)(PL - 128) * 512 + 256, 512, cv_p + (size_t)bs * 128 * 256, 256, 128, 256); }
            }
            if (l < 2) {
                k_gemm<<<dim3(2048 / 64, L / 64), 256, 0, st>>>(B.hm, D, w_in_a + (size_t)l * D * 2048, 2048, B.uz, 2048, D);
                if (hook) { hook(hctx, seq, l, ST_U, B.uz, 2048, L, D, st); hook(hctx, seq, l, ST_Z, B.uz + 1024, 2048, L, D, st); }
                float* hl = samp ? st_s + ((size_t)l * NSB + bs) * G * P * 2 : st_p + ((size_t)l * NPB + bs) * G * P * 2;
                const float* h0 = samp ? state_ssm + ((size_t)l * NSB + bs) * G * P * 2 : nullptr;
                k_s5<<<G, 64, 0, st>>>(B.uz, L, B.abar + (size_t)l * G * P * 2, B.bbar + (size_t)l * G * P * GC * 2, c_re + (size_t)l * G * GC * P, c_im + (size_t)l * G * GC * P, ssm_d + l * D, h0, B.y, hl);
                if (hook) hook(hctx, seq, l, ST_Y, B.y, D, L, D, st);
                k_gelu<<<(n + 255) / 256, 256, 0, st>>>(B.y, n);
                if (hook) hook(hctx, seq, l, ST_G, B.y, D, L, D, st);
                k_gemm<<<dim3(D / 64, L / 64), 256, 0, st>>>(B.y, D, w_glu + (size_t)l * D * D, D, B.t, D, D);
                k_glu<<<(n + 255) / 256, 256, 0, st>>>(B.y, B.t, b_glu + l * D, B.uz, B.y2, n);
                if (hook) hook(hctx, seq, l, ST_Y2, B.y2, D, L, D, st);
                k_gemm<<<dim3(D / 64, L / 64), 256, 0, st>>>(B.y2, D, w_out_a + (size_t)l * D * D, D, B.t, D, D);
            } else {
                const int lb = l - 2;
                k_gemm<<<dim3(2048 / 64, L / 64), 256, 0, st>>>(B.hm, D, w_in_b + (size_t)lb * D * 2048, 2048, B.uz, 2048, D);
                k_rope<<<(L * H * 32 + 255) / 256, 256, 0, st>>>(B.uz, 2048, H, L, samp ? 1024 : 0);
                if (hook) { hook(hctx, seq, l, ST_Q, B.uz, 2048, L, D, st); hook(hctx, seq, l, ST_Z, B.uz + 1024, 2048, L, D, st); }
                k_attn<<<(L * H + 63) / 64, 64, 0, st>>>(B.uz, B.kv, B.kv + 256, 512, samp ? cache_k + (size_t)bs * 128 * 256 : nullptr, samp ? cache_v + (size_t)bs * 128 * 256 : nullptr, samp ? 128 : 0,
                                                           sinks + lb * H, L, B.y2);
                if (hook) hook(hctx, seq, l, ST_O, B.y2, D, L, D, st);
                k_gemm<<<dim3(D / 64, L / 64), 256, 0, st>>>(B.y2, D, w_out_b + (size_t)lb * D * D, D, B.t, D, D);
            }
            if (hook) hook(hctx, seq, l, ST_OUT, B.t, D, L, D, st);
            k_ln<<<L, 256, 0, st>>>(xc, B.t, cond_lb, ln_g + l * D, ln_b + l * D, xn);
            if (hook) hook(hctx, seq, l, ST_X, xn, D, L, D, st);
            xc = xn;
        }
    }
}
constexpr size_t WS_BYTES = (size_t)96 << 20;
}
extern "C" void kernel_launch(void* const* d_in, const int* in_sizes, int n_in, void* d_out, int out_size, void* d_ws, size_t ws_size, hipStream_t stream) {
    gold::run(d_in, (float*)d_out, (char*)d_ws, stream, nullptr, nullptr);
}
```
